# Optimizing an MI355X kernel written in HIP

```python
import math
import jax, jax.numpy as jnp
from jax import lax
import numpy as np

D_MODEL = 1024
BATCH = 8
SEQ = 2048
DEPTH = 1

HEAD_DIM = 64
N_HEADS = 8
N_KV_HEADS = 2
WINDOW = 128
BLOCK = 128
NUM_BUCKETS = 32
MAX_DISTANCE = 128
CONV_CH = 512
CONV_WIDTH = 31
D_FF = int(math.ceil(8 * D_MODEL / 3 / 256) * 256)
Q_COLS = N_HEADS * HEAD_DIM
KV_COLS = N_KV_HEADS * HEAD_DIM
CONV_COLS = 2 * CONV_CH
GATE_COLS = 2 * D_MODEL
IN_COLS = Q_COLS + 2 * KV_COLS + CONV_COLS + GATE_COLS
ALPHA = (2.0 * DEPTH) ** 0.25
BETA = (8.0 * DEPTH) ** -0.25
LN_EPS = 1e-5
NEG_INF = -1e30

kernel_name = "hybrid_gated_conformer_swa_encoder"


def layer_norm(x, g, b):
    xf = x.astype(jnp.float32)
    mu = jnp.mean(xf, axis=-1, keepdims=True)
    var = jnp.mean(jnp.square(xf - mu), axis=-1, keepdims=True)
    y = (xf - mu) * lax.rsqrt(var + LN_EPS) * g.astype(jnp.float32) + b.astype(jnp.float32)
    return y.astype(x.dtype)


def _t5_buckets(rel):
    nb = NUM_BUCKETS // 2
    ret = (rel > 0).astype(np.int32) * nb
    n = np.abs(rel)
    max_exact = nb // 2
    large = max_exact + (np.log(np.maximum(n, 1) / max_exact)
                         / np.log(MAX_DISTANCE / max_exact) * (nb - max_exact)).astype(np.int32)
    large = np.minimum(large, nb - 1)
    return (ret + np.where(n < max_exact, n, large)).astype(np.int32)


def windowed_gqa(q, k, v, rel_bias, sink):
    B, S, _ = q.shape
    nblk = S // BLOCK
    R = N_HEADS // N_KV_HEADS
    qb = q.reshape(B, nblk, BLOCK, N_KV_HEADS, R, HEAD_DIM)
    pad = ((0, 0), (BLOCK, BLOCK), (0, 0))
    kp = jnp.pad(k, pad).reshape(B, nblk + 2, BLOCK, N_KV_HEADS, HEAD_DIM)
    vp = jnp.pad(v, pad).reshape(B, nblk + 2, BLOCK, N_KV_HEADS, HEAD_DIM)
    kb = jnp.concatenate([kp[:, :-2], kp[:, 1:-1], kp[:, 2:]], axis=2)
    vb = jnp.concatenate([vp[:, :-2], vp[:, 1:-1], vp[:, 2:]], axis=2)

    qi = np.arange(BLOCK)[:, None]
    kj = np.arange(3 * BLOCK)[None, :]
    rel = kj - BLOCK - qi
    win = np.abs(rel) <= WINDOW
    kpos = (np.arange(nblk)[:, None] - 1) * BLOCK + np.arange(3 * BLOCK)[None, :]
    valid = (kpos >= 0) & (kpos < S)
    mask = jnp.asarray(win[None, :, :] & valid[:, None, :])
    buckets = jnp.asarray(_t5_buckets(rel))
    bias = jnp.transpose(rel_bias.astype(jnp.float32)[buckets], (2, 0, 1))
    bias = bias.reshape(N_KV_HEADS, R, BLOCK, 3 * BLOCK)

    scale = HEAD_DIM ** -0.5
    s = jnp.einsum('bnqgrd,bnkgd->bngrqk', qb.astype(jnp.float32), kb.astype(jnp.float32)) * scale
    s = s + bias[None, None]
    s = jnp.where(mask[None, :, None, None, :, :], s, NEG_INF)
    sink_col = jnp.broadcast_to(sink.astype(jnp.float32).reshape(1, 1, N_KV_HEADS, R, 1, 1),
                                s.shape[:-1] + (1,))
    p = jax.nn.softmax(jnp.concatenate([s, sink_col], axis=-1), axis=-1)[..., :-1]
    o = jnp.einsum('bngrqk,bnkgd->bnqgrd', p.astype(v.dtype), vb)
    return o.reshape(B, S, N_HEADS * HEAD_DIM)


def conformer_conv(u, conv_w, conv_b, ln_g, ln_b):
    glu = u[..., :CONV_CH] * jax.nn.sigmoid(u[..., CONV_CH:])
    dw = lax.conv_general_dilated(
        glu, conv_w[:, None, :].astype(glu.dtype), window_strides=(1,),
        padding=[((CONV_WIDTH - 1) // 2, (CONV_WIDTH - 1) // 2)],
        dimension_numbers=('NWC', 'WIO', 'NWC'), feature_group_count=CONV_CH)
    dw = dw + conv_b
    return jax.nn.silu(layer_norm(dw, ln_g, ln_b))


def setup_inputs(seed: int = 0) -> dict:
    key = jax.random.key(seed)
    ks = jax.random.split(key, 24)
    f32 = jnp.float32
    nrm = lambda k, shp, s: jax.random.normal(k, shp, f32) * s
    gain = lambda k, shp: 1.0 + nrm(k, shp, 0.02)
    w_in = nrm(ks[1], (DEPTH, D_MODEL, IN_COLS), D_MODEL ** -0.5)
    v0 = Q_COLS + KV_COLS
    w_in = w_in.at[:, :, v0:v0 + KV_COLS].multiply(BETA)
    return {
        "x": jax.random.normal(ks[0], (BATCH, SEQ, D_MODEL), f32),
        "ln_in_g": gain(ks[2], (D_MODEL,)),
        "ln_in_b": nrm(ks[3], (D_MODEL,), 0.02),
        "rel_bias": nrm(ks[4], (NUM_BUCKETS, N_HEADS), 0.1),
        "w_in": w_in,
        "b_gate": nrm(ks[5], (DEPTH, GATE_COLS), 0.02),
        "conv_w": nrm(ks[6], (DEPTH, CONV_WIDTH, CONV_CH), CONV_WIDTH ** -0.5),
        "conv_b": nrm(ks[7], (DEPTH, CONV_CH), 0.02),
        "conv_ln_g": gain(ks[8], (DEPTH, CONV_CH)),
        "conv_ln_b": nrm(ks[9], (DEPTH, CONV_CH), 0.02),
        "w_conv_out": nrm(ks[10], (DEPTH, CONV_CH, D_MODEL), BETA * CONV_CH ** -0.5),
        "w_attn_out": nrm(ks[11], (DEPTH, Q_COLS, D_MODEL), BETA * Q_COLS ** -0.5),
        "sink": nrm(ks[12], (DEPTH, N_HEADS), 0.5),
        "w_out": nrm(ks[13], (DEPTH, D_MODEL, D_MODEL), BETA * D_MODEL ** -0.5),
        "ln1_g": gain(ks[14], (DEPTH, D_MODEL)),
        "ln1_b": nrm(ks[15], (DEPTH, D_MODEL), 0.02),
        "w_gate": nrm(ks[16], (DEPTH, D_MODEL, D_FF), BETA * D_MODEL ** -0.5),
        "w_up": nrm(ks[17], (DEPTH, D_MODEL, D_FF), BETA * D_MODEL ** -0.5),
        "w_down": nrm(ks[18], (DEPTH, D_FF, D_MODEL), BETA * D_FF ** -0.5),
        "ln2_g": gain(ks[19], (DEPTH, D_MODEL)),
        "ln2_b": nrm(ks[20], (DEPTH, D_MODEL), 0.02),
    }


def reference(x, ln_in_g, ln_in_b, rel_bias, w_in, b_gate, conv_w, conv_b, conv_ln_g,
              conv_ln_b, w_conv_out, w_attn_out, sink, w_out, ln1_g, ln1_b,
              w_gate, w_up, w_down, ln2_g, ln2_b):
    x = layer_norm(x, ln_in_g, ln_in_b)
    o1 = Q_COLS
    o2 = o1 + KV_COLS
    o3 = o2 + KV_COLS
    o4 = o3 + CONV_COLS
    for l in range(DEPTH):
        u = jnp.einsum('bsd,dc->bsc', x, w_in[l])
        q, k, v = u[..., :o1], u[..., o1:o2], u[..., o2:o3]
        y_a = windowed_gqa(q, k, v, rel_bias, sink[l]) @ w_attn_out[l]
        y_c = conformer_conv(u[..., o3:o4], conv_w[l], conv_b[l],
                             conv_ln_g[l], conv_ln_b[l]) @ w_conv_out[l]
        gates = jax.nn.sigmoid(u[..., o4:] + b_gate[l])
        merged = gates[..., :D_MODEL] * y_a + gates[..., D_MODEL:] * y_c
        mix = merged @ w_out[l]
        x = layer_norm(ALPHA * x + mix, ln1_g[l], ln1_b[l])
        hid = jax.nn.silu(x @ w_gate[l]) * (x @ w_up[l])
        x = layer_norm(ALPHA * x + hid @ w_down[l], ln2_g[l], ln2_b[l])
    return x
```

```cpp
#include <hip/hip_runtime.h>
#include <cstdio>
#include <cstdint>

namespace {
constexpr int D_MODEL = 1024, BATCH = 8, SEQ = 2048;
constexpr int Q_COLS = 512, KV_COLS = 128, CONV_CH = 512, IN_COLS = 3840, D_FF = 2816;
constexpr int O_K = 512, O_V = 640, O_CA = 768, O_CB = 1280, O_GA = 1792, O_GC = 2816;
constexpr float ALPHA = 1.189207115002721f;
constexpr float LN_EPS = 1e-5f;

__device__ __forceinline__ float block_sum(float v, float* red, int nthreads) {
    for (int o = 32; o > 0; o >>= 1) v += __shfl_xor(v, o);
    const int w = threadIdx.x >> 6, nw = nthreads >> 6;
    __syncthreads();
    if ((threadIdx.x & 63) == 0) red[w] = v;
    __syncthreads();
    float s = 0.f;
    for (int i = 0; i < nw; ++i) s += red[i];
    return s;
}

__global__ __launch_bounds__(256) void ln_in_kernel(const float* __restrict__ x, const float* __restrict__ g, const float* __restrict__ b, float* __restrict__ y) {
    __shared__ float red[8];
    const size_t row = blockIdx.x;
    const float4 v = ((const float4*)(x + row * D_MODEL))[threadIdx.x];
    const float mean = block_sum((v.x + v.y) + (v.z + v.w), red, 256) * (1.f / D_MODEL);
    const float dx = v.x - mean, dy = v.y - mean, dz = v.z - mean, dw = v.w - mean;
    const float var = block_sum((dx * dx + dy * dy) + (dz * dz + dw * dw), red, 256) * (1.f / D_MODEL);
    const float rs = 1.0f / sqrtf(var + LN_EPS);
    const float4 gg = ((const float4*)g)[threadIdx.x], bb = ((const float4*)b)[threadIdx.x];
    float4 o; o.x = dx * rs * gg.x + bb.x; o.y = dy * rs * gg.y + bb.y; o.z = dz * rs * gg.z + bb.z; o.w = dw * rs * gg.w + bb.w;
    ((float4*)(y + row * D_MODEL))[threadIdx.x] = o;
}

__global__ __launch_bounds__(256) void resid_ln_kernel(const float* __restrict__ res, const float* __restrict__ add, const float* __restrict__ g, const float* __restrict__ b, float* __restrict__ y) {
    __shared__ float red[8];
    const size_t row = blockIdx.x;
    const float4 r = ((const float4*)(res + row * D_MODEL))[threadIdx.x];
    const float4 a = ((const float4*)(add + row * D_MODEL))[threadIdx.x];
    float4 v; v.x = ALPHA * r.x + a.x; v.y = ALPHA * r.y + a.y; v.z = ALPHA * r.z + a.z; v.w = ALPHA * r.w + a.w;
    const float mean = block_sum((v.x + v.y) + (v.z + v.w), red, 256) * (1.f / D_MODEL);
    const float dx = v.x - mean, dy = v.y - mean, dz = v.z - mean, dw = v.w - mean;
    const float var = block_sum((dx * dx + dy * dy) + (dz * dz + dw * dw), red, 256) * (1.f / D_MODEL);
    const float rs = 1.0f / sqrtf(var + LN_EPS);
    const float4 gg = ((const float4*)g)[threadIdx.x], bb = ((const float4*)b)[threadIdx.x];
    float4 o; o.x = dx * rs * gg.x + bb.x; o.y = dy * rs * gg.y + bb.y; o.z = dz * rs * gg.z + bb.z; o.w = dw * rs * gg.w + bb.w;
    ((float4*)(y + row * D_MODEL))[threadIdx.x] = o;
}

__global__ __launch_bounds__(256) void sgemm_kernel(const float* __restrict__ A, int lda, const float* __restrict__ W, int ldw, float* __restrict__ C, int ldc, int K) {
    __shared__ float As[16][68];
    __shared__ float Ws[16][68];
    const int tx = threadIdx.x & 15, ty = threadIdx.x >> 4;
    const int m0 = blockIdx.y * 64, n0 = blockIdx.x * 64;
    float c00 = 0, c01 = 0, c02 = 0, c03 = 0, c10 = 0, c11 = 0, c12 = 0, c13 = 0, c20 = 0, c21 = 0, c22 = 0, c23 = 0, c30 = 0, c31 = 0, c32 = 0, c33 = 0;
    const int ar = threadIdx.x >> 2, ac = (threadIdx.x & 3) * 4;
    const int wr = threadIdx.x >> 4, wc = (threadIdx.x & 15) * 4;
    for (int k0 = 0; k0 < K; k0 += 16) {
        const float4 av = *(const float4*)(A + (size_t)(m0 + ar) * lda + k0 + ac);
        const float4 wv = *(const float4*)(W + (size_t)(k0 + wr) * ldw + n0 + wc);
        __syncthreads();
        As[ac + 0][ar] = av.x; As[ac + 1][ar] = av.y; As[ac + 2][ar] = av.z; As[ac + 3][ar] = av.w;
        *(float4*)&Ws[wr][wc] = wv;
        __syncthreads();
#pragma unroll
        for (int k = 0; k < 16; ++k) {
            const float4 a = *(const float4*)&As[k][ty * 4];
            const float4 b = *(const float4*)&Ws[k][tx * 4];
            c00 += a.x * b.x; c01 += a.x * b.y; c02 += a.x * b.z; c03 += a.x * b.w;
            c10 += a.y * b.x; c11 += a.y * b.y; c12 += a.y * b.z; c13 += a.y * b.w;
            c20 += a.z * b.x; c21 += a.z * b.y; c22 += a.z * b.z; c23 += a.z * b.w;
            c30 += a.w * b.x; c31 += a.w * b.y; c32 += a.w * b.z; c33 += a.w * b.w;
        }
    }
    float* cp = C + (size_t)(m0 + ty * 4) * ldc + n0 + tx * 4;
    *(float4*)(cp) = make_float4(c00, c01, c02, c03);
    *(float4*)(cp + ldc) = make_float4(c10, c11, c12, c13);
    *(float4*)(cp + 2 * (size_t)ldc) = make_float4(c20, c21, c22, c23);
    *(float4*)(cp + 3 * (size_t)ldc) = make_float4(c30, c31, c32, c33);
}

__device__ __forceinline__ int t5_bucket(int rel) {
    const int n = rel < 0 ? -rel : rel;
    int v;
    if (n < 8) v = n;
    else v = 8 + (n >= 12) + (n >= 16) + (n >= 23) + (n >= 32) + (n >= 46) + (n >= 64) + (n >= 91);
    return v + (rel > 0 ? 16 : 0);
}

__global__ __launch_bounds__(512) void attn_naive_kernel(const float* __restrict__ u, const float* __restrict__ rel_bias, const float* __restrict__ sink, float* __restrict__ o) {
    __shared__ float qs[8][64];
    __shared__ float ps[8][384];
    const int t = blockIdx.x, hq = threadIdx.x >> 6, lane = threadIdx.x & 63, g = hq >> 2;
    qs[hq][lane] = u[(size_t)t * IN_COLS + hq * 64 + lane];
    __syncthreads();
    const int blk = t >> 7, qi = t & 127;
    const float sk = sink[hq];
    float sc0, sc1, sc2, sc3, sc4, sc5;
    float mx = sk;
#define SCORE(i, dst) { const int kj = lane + 64 * (i); const int kpos = (blk - 1) * 128 + kj; const int rel = kj - 128 - qi; \
        const bool valid = (rel >= -128) && (rel <= 128) && (kpos >= 0) && (kpos < SEQ); float s = -1e30f; \
        if (valid) { const float* kr = u + (size_t)kpos * IN_COLS + O_K + g * 64; float dot = 0.f; for (int d = 0; d < 64; ++d) dot += qs[hq][d] * kr[d]; \
            s = dot * 0.125f + rel_bias[t5_bucket(rel) * 8 + hq]; } dst = s; mx = fmaxf(mx, s); }
    SCORE(0, sc0) SCORE(1, sc1) SCORE(2, sc2) SCORE(3, sc3) SCORE(4, sc4) SCORE(5, sc5)
#undef SCORE
    for (int off = 32; off > 0; off >>= 1) mx = fmaxf(mx, __shfl_xor(mx, off));
    const float e0 = expf(sc0 - mx), e1 = expf(sc1 - mx), e2 = expf(sc2 - mx), e3 = expf(sc3 - mx), e4 = expf(sc4 - mx), e5 = expf(sc5 - mx);
    float sum = ((e0 + e1) + (e2 + e3)) + (e4 + e5);
    for (int off = 32; off > 0; off >>= 1) sum += __shfl_xor(sum, off);
    sum += expf(sk - mx);
    const float inv = 1.0f / sum;
    ps[hq][lane] = e0 * inv; ps[hq][lane + 64] = e1 * inv; ps[hq][lane + 128] = e2 * inv; ps[hq][lane + 192] = e3 * inv; ps[hq][lane + 256] = e4 * inv; ps[hq][lane + 320] = e5 * inv;
    __syncthreads();
    float acc = 0.f;
    for (int kj = 0; kj < 384; ++kj) {
        const int kpos = (blk - 1) * 128 + kj;
        if (kpos < 0 || kpos >= SEQ) continue;
        const float p = ps[hq][kj];
        acc += p * u[(size_t)kpos * IN_COLS + O_V + g * 64 + lane];
    }
    o[(size_t)t * Q_COLS + hq * 64 + lane] = acc;
}

__global__ __launch_bounds__(512) void conv_naive_kernel(const float* __restrict__ u, const float* __restrict__ cw, const float* __restrict__ cb, const float* __restrict__ lg, const float* __restrict__ lb, float* __restrict__ out) {
    __shared__ float red[8];
    const int t = blockIdx.x, c = threadIdx.x;
    float acc = cb[c];
    for (int w = 0; w < 31; ++w) {
        const int tt = t + w - 15;
        if (tt < 0 || tt >= SEQ) continue;
        const float a = u[(size_t)tt * IN_COLS + O_CA + c], b = u[(size_t)tt * IN_COLS + O_CB + c];
        const float glu = a / (1.0f + expf(-b));
        acc += glu * cw[w * CONV_CH + c];
    }
    const float mean = block_sum(acc, red, 512) * (1.f / CONV_CH);
    const float d = acc - mean;
    const float var = block_sum(d * d, red, 512) * (1.f / CONV_CH);
    const float y = d * (1.0f / sqrtf(var + LN_EPS)) * lg[c] + lb[c];
    out[(size_t)t * CONV_CH + c] = y / (1.0f + expf(-y));
}

__global__ __launch_bounds__(256) void merge_kernel(const float* __restrict__ u, const float* __restrict__ bg, float* __restrict__ ya, const float* __restrict__ yc) {
    const int t = blockIdx.x;
    for (int j = threadIdx.x; j < D_MODEL; j += 256) {
        const float ga = 1.0f / (1.0f + expf(-(u[(size_t)t * IN_COLS + O_GA + j] + bg[j])));
        const float gc = 1.0f / (1.0f + expf(-(u[(size_t)t * IN_COLS + O_GC + j] + bg[D_MODEL + j])));
        const size_t i = (size_t)t * D_MODEL + j;
        ya[i] = ga * ya[i] + gc * yc[i];
    }
}

__global__ __launch_bounds__(256) void swiglu_kernel(float* __restrict__ gate, const float* __restrict__ up, size_t n) {
    const size_t i = (size_t)blockIdx.x * 256 + threadIdx.x;
    if (i < n) { const float gv = gate[i]; gate[i] = gv / (1.0f + expf(-gv)) * up[i]; }
}
}

extern "C" void kernel_launch(void* const* d_in, const int* in_sizes, int n_in, void* d_out, int out_size, void* d_ws, size_t ws_size, hipStream_t stream) {
    const float* x = (const float*)d_in[0];
    const float* ln_in_g = (const float*)d_in[1];
    const float* ln_in_b = (const float*)d_in[2];
    const float* rel_bias = (const float*)d_in[3];
    const float* w_in = (const float*)d_in[4];
    const float* b_gate = (const float*)d_in[5];
    const float* conv_w = (const float*)d_in[6];
    const float* conv_b = (const float*)d_in[7];
    const float* conv_ln_g = (const float*)d_in[8];
    const float* conv_ln_b = (const float*)d_in[9];
    const float* w_conv_out = (const float*)d_in[10];
    const float* w_attn_out = (const float*)d_in[11];
    const float* sink = (const float*)d_in[12];
    const float* w_out = (const float*)d_in[13];
    const float* ln1_g = (const float*)d_in[14];
    const float* ln1_b = (const float*)d_in[15];
    const float* w_gate = (const float*)d_in[16];
    const float* w_up = (const float*)d_in[17];
    const float* w_down = (const float*)d_in[18];
    const float* ln2_g = (const float*)d_in[19];
    const float* ln2_b = (const float*)d_in[20];
    float* out = (float*)d_out;
    float* ws = (float*)d_ws;
    const size_t S = SEQ;
    float* xn = ws;
    float* u = xn + S * D_MODEL;
    float* o = u + S * IN_COLS;
    float* cc = o + S * Q_COLS;
    float* ya = cc + S * CONV_CH;
    float* yc = ya + S * D_MODEL;
    float* mix = yc + S * D_MODEL;
    float* h = mix + S * D_MODEL;
    float* gate = h + S * D_MODEL;
    float* up = gate + S * D_FF;
    float* down = up + S * D_FF;
    for (int b = 0; b < BATCH; ++b) {
        const float* xb = x + (size_t)b * S * D_MODEL;
        float* ob = out + (size_t)b * S * D_MODEL;
        ln_in_kernel<<<SEQ, 256, 0, stream>>>(xb, ln_in_g, ln_in_b, xn);
        sgemm_kernel<<<dim3(IN_COLS / 64, SEQ / 64), 256, 0, stream>>>(xn, D_MODEL, w_in, IN_COLS, u, IN_COLS, D_MODEL);
        attn_naive_kernel<<<SEQ, 512, 0, stream>>>(u, rel_bias, sink, o);
        conv_naive_kernel<<<SEQ, 512, 0, stream>>>(u, conv_w, conv_b, conv_ln_g, conv_ln_b, cc);
        sgemm_kernel<<<dim3(D_MODEL / 64, SEQ / 64), 256, 0, stream>>>(o, Q_COLS, w_attn_out, D_MODEL, ya, D_MODEL, Q_COLS);
        sgemm_kernel<<<dim3(D_MODEL / 64, SEQ / 64), 256, 0, stream>>>(cc, CONV_CH, w_conv_out, D_MODEL, yc, D_MODEL, CONV_CH);
        merge_kernel<<<SEQ, 256, 0, stream>>>(u, b_gate, ya, yc);
        sgemm_kernel<<<dim3(D_MODEL / 64, SEQ / 64), 256, 0, stream>>>(ya, D_MODEL, w_out, D_MODEL, mix, D_MODEL, D_MODEL);
        resid_ln_kernel<<<SEQ, 256, 0, stream>>>(xn, mix, ln1_g, ln1_b, h);
        sgemm_kernel<<<dim3(D_FF / 64, SEQ / 64), 256, 0, stream>>>(h, D_MODEL, w_gate, D_FF, gate, D_FF, D_MODEL);
        sgemm_kernel<<<dim3(D_FF / 64, SEQ / 64), 256, 0, stream>>>(h, D_MODEL, w_up, D_FF, up, D_FF, D_MODEL);
        swiglu_kernel<<<(unsigned)((S * D_FF + 255) / 256), 256, 0, stream>>>(gate, up, S * D_FF);
        sgemm_kernel<<<dim3(D_MODEL / 64, SEQ / 64), 256, 0, stream>>>(gate, D_FF, w_down, D_MODEL, down, D_MODEL, D_FF);
        resid_ln_kernel<<<SEQ, 256, 0, stream>>>(h, down, ln2_g, ln2_b, ob);
    }
}
```

```cpp
#include <hip/hip_runtime.h>
#include <cstdio>
#include <cstdint>
namespace pg8 {
#define PG8_LAS __attribute__((address_space(3)))
typedef unsigned short bf16_t;
typedef short bf16x8 __attribute__((ext_vector_type(8)));
typedef float f32x4 __attribute__((ext_vector_type(4)));
typedef unsigned u32x4 __attribute__((ext_vector_type(4)));
constexpr int BM = 256, BK = 64, HALF = 128, HTB = HALF * BK * 2  , STAGE_BYTES = 8 * HTB, NXCD = 8, WGM = 8;

__host__ __device__ __forceinline__ int lds_byte(int r, int c) { const int st = (r >> 4) * 2 + (c >> 5), rr = r & 15, cc = c & 31, ob = rr * 64 + cc * 2; return st * 1024 + (ob ^ (((ob >> 9) & 1) << 5)); }
__host__ __device__ __forceinline__ void stage_rc(int b, int& R, int& C) { const int st = b / 1024, sb = b % 1024, swz = sb ^ (((sb >> 9) & 1) << 5); R = (st >> 1) * 16 + swz / 64; C = (st & 1) * 32 + (swz % 64) / 2; }
__host__ __device__ __forceinline__ int perm32(int rho) { const int n = rho >> 4, i = rho & 15; return 8 * (i >> 2) + 4 * n + (i & 3); }

struct Unit { int pm, pn; };
struct Gemm { const bf16_t* A; const bf16_t* Bt; int M, N, K; };

struct StaticOrder {
    int nM, nN, nwg, G, c;
    __host__ __device__ void init(int M, int N, int G_, int c_) { nM = M / BM; nN = N / BM; nwg = nM * nN; G = G_; c = c_; }
    __host__ __device__ bool next(int i, Unit& u) const {
        const long L = (long)i * G + c; if (L >= nwg) return false;
        int wgid = (int)L; { const int q = nwg / NXCD, r = nwg % NXCD, xcd = wgid % NXCD, off = wgid / NXCD; wgid = (xcd < r ? xcd * (q + 1) : r * (q + 1) + (xcd - r) * q) + off; }
        const int nig = WGM * nN, gid = wgid / nig, fm = gid * WGM, gsz = (nM - fm) < WGM ? (nM - fm) : WGM;
        u.pm = fm + ((wgid % nig) % gsz); u.pn = (wgid % nig) / gsz; return true;
    }
    __device__ __forceinline__ void a_ready(const Unit&) const {}
    __device__ __forceinline__ void done(const Unit&) const {}
};

__device__ __forceinline__ unsigned cvt_pk_bf16(float lo, float hi) { unsigned r; asm volatile("v_cvt_pk_bf16_f32 %0, %1, %2" : "=v"(r) : "v"(lo), "v"(hi)); return r; }
typedef float f32x2 __attribute__((ext_vector_type(2)));
__device__ __forceinline__ f32x2 gelu_pk(f32x2 v) {
    const f32x2 av = __builtin_elementwise_abs(v), d = av * 0.2316418882f + 1.0f;
    f32x2 t; t.x = __builtin_amdgcn_rcpf(d.x); t.y = __builtin_amdgcn_rcpf(d.y);
    f32x2 q = t * 0.5307027145f + (-0.7265760135f); q = q * t + 0.7107068705f; q = q * t + (-0.142248368f); q = q * t + 0.127414796f; q = q * t;
    const f32x2 s = (v * v) * (-0.72134752044f);
    f32x2 e; e.x = __builtin_amdgcn_exp2f(s.x); e.y = __builtin_amdgcn_exp2f(s.y);
    const f32x2 m = v * (q * e), r = v - m;
    f32x2 o; o.x = v.x < 0.f ? m.x : r.x; o.y = v.y < 0.f ? m.y : r.y; return o;
}

template <int ACT  > struct EpiBf16 {
    static constexpr bool PERM = true, AFTER_DRAIN = false, HAS_MID = false; static_assert(ACT == 0 || ACT == 1, "EpiBf16: ACT is 0 (none) or 1 (gelu_pk)");
    bf16_t* O; int ldc; const float* bias; int split_cols; size_t split_stride; float scale0;
    __device__ __forceinline__ void operator()(const f32x4 (&acc)[2][2][4][2], const Unit& u, int wr, int wc, int fr, int fq) const {
        const int row0 = u.pm * BM + wr * 64 + fr; int colt = u.pn * BM; bf16_t* base = O;
        float sc = 1.f; if (split_cols) { const int t = colt / split_cols; base += (size_t)t * split_stride; colt -= t * split_cols; if (t == 0) sc = scale0; }
        const int col0 = colt + wc * 32 + 8 * fq, bcol0 = u.pn * BM + wc * 32 + 8 * fq;
        f32x4 bv[2][2];
#pragma unroll
        for (int bj = 0; bj < 2; ++bj)
#pragma unroll
            for (int n = 0; n < 2; ++n) bv[bj][n] = bias ? *(const f32x4*)(bias + bcol0 + bj * HALF + 4 * n) : (f32x4){0.f, 0.f, 0.f, 0.f};
#pragma unroll
        for (int ai = 0; ai < 2; ++ai)
#pragma unroll
            for (int m = 0; m < 4; ++m) { bf16_t* rowp = base + (size_t)(row0 + ai * HALF + m * 16) * ldc + col0;
#pragma unroll
                for (int bj = 0; bj < 2; ++bj) { f32x4 v0 = acc[ai][bj][m][0] + bv[bj][0], v1 = acc[ai][bj][m][1] + bv[bj][1];
                    if (ACT == 1) { f32x2 a = gelu_pk((f32x2){v0[0], v0[1]}), b = gelu_pk((f32x2){v0[2], v0[3]}), c = gelu_pk((f32x2){v1[0], v1[1]}), d = gelu_pk((f32x2){v1[2], v1[3]});
                        v0 = (f32x4){a.x, a.y, b.x, b.y}; v1 = (f32x4){c.x, c.y, d.x, d.y}; }
                    v0 = v0 * sc; v1 = v1 * sc; u32x4 w; w.x = cvt_pk_bf16(v0[0], v0[1]); w.y = cvt_pk_bf16(v0[2], v0[3]); w.z = cvt_pk_bf16(v1[0], v1[1]); w.w = cvt_pk_bf16(v1[2], v1[3]);
                    *(u32x4*)(rowp + bj * HALF) = w; } }
    }
};

struct PanelStats {
    unsigned* xbuf;
    unsigned* cnt;
    unsigned* tmo;
    int ntn; float eps;
    unsigned code;
    __device__ __forceinline__ bool run(const f32x4 (&v)[2][2][4][2], const Unit& u, int wr, int wc, int fr, int fq, PG8_LAS unsigned char* lds, int wid, int lane) const {
        typedef float f32x2v __attribute__((ext_vector_type(2)));
        PG8_LAS f32x2v* P = (PG8_LAS f32x2v*)lds;
        PG8_LAS f32x2v* S = (PG8_LAS f32x2v*)(lds + 8192);
        PG8_LAS unsigned* flag = (PG8_LAS unsigned*)(lds + 8192 + 2048);
#pragma unroll
        for (int ai = 0; ai < 2; ++ai)
#pragma unroll
            for (int m = 0; m < 4; ++m) {
                float s = 0.f;
#pragma unroll
                for (int bj = 0; bj < 2; ++bj)
#pragma unroll
                    for (int n = 0; n < 2; ++n) { const f32x4 x = v[ai][bj][m][n]; s += (x[0] + x[1]) + (x[2] + x[3]); }
                s += __shfl_xor(s, 16); s += __shfl_xor(s, 32);
                const float mw = s * (1.0f / 64.0f); float q = 0.f;
#pragma unroll
                for (int bj = 0; bj < 2; ++bj)
#pragma unroll
                    for (int n = 0; n < 2; ++n) { const f32x4 d = v[ai][bj][m][n] - mw; q += (d[0] * d[0] + d[1] * d[1]) + (d[2] * d[2] + d[3] * d[3]); }
                q += __shfl_xor(q, 16); q += __shfl_xor(q, 32);
                if (fq == 0) P[(ai * HALF + wr * 64 + m * 16 + fr) * 4 + wc] = (f32x2v){mw, q};
            }
        asm volatile("s_waitcnt lgkmcnt(0)" ::: "memory"); __builtin_amdgcn_s_barrier(); asm volatile("" ::: "memory");
#if defined(BROKEN_EXCHANGE_NO_WAIT)
#warning BROKEN CONTROL BUILD: the row-statistics exchange does not wait; results are wrong by design
        if (blockIdx.x >= 64) { const long long t0_ = clock64(); while (clock64() - t0_ < 60000) __builtin_amdgcn_s_sleep(8); }
#endif
        const int row = wid * 32 + (lane & 31);
        if (lane < 32) {
            const f32x2v a = P[row * 4 + 0], b = P[row * 4 + 1], c = P[row * 4 + 2], d = P[row * 4 + 3];
            const float mt = (a.x + b.x + c.x + d.x) * 0.25f;
            const float da = a.x - mt, db = b.x - mt, dc = c.x - mt, dd = d.x - mt;
            const float m2 = (a.y + b.y) + (c.y + d.y) + 64.0f * ((da * da + db * db) + (dc * dc + dd * dd));
            unsigned long long* slot = (unsigned long long*)xbuf + ((size_t)(u.pm * BM + row) * 4 + u.pn);
            __hip_atomic_store(slot, ((unsigned long long)__float_as_uint(m2) << 32) | __float_as_uint(mt), __ATOMIC_RELAXED, __HIP_MEMORY_SCOPE_AGENT);
        }
        asm volatile("s_waitcnt vmcnt(0)" ::: "memory");
        if (lane == 0) __hip_atomic_fetch_add(cnt + 64 * u.pm, 1u, __ATOMIC_RELAXED, __HIP_MEMORY_SCOPE_AGENT);
        if (wid == 0) {
            bool dead = false; const unsigned long long t0 = __builtin_amdgcn_s_memrealtime(); const unsigned want = 8u * (unsigned)ntn;
            for (;;) {
#if defined(BROKEN_EXCHANGE_NO_WAIT)
                break;
#endif
                if ((unsigned)__builtin_amdgcn_readfirstlane(__hip_atomic_load(cnt + 64 * u.pm, __ATOMIC_RELAXED, __HIP_MEMORY_SCOPE_AGENT)) >= want) break;
                if (__builtin_amdgcn_s_memrealtime() - t0 > 2000000ull) {
                    if (lane == 0) { unsigned expect = 0u; __hip_atomic_compare_exchange_strong(tmo + 1, &expect, code | (unsigned)(u.pm & 0xff), __ATOMIC_RELAXED, __ATOMIC_RELAXED, __HIP_MEMORY_SCOPE_AGENT);
                                     __hip_atomic_store(tmo, 1u, __ATOMIC_RELAXED, __HIP_MEMORY_SCOPE_AGENT); }
                    dead = true; break; }
                __builtin_amdgcn_s_sleep(2);
            }
            __builtin_amdgcn_fence(__ATOMIC_ACQUIRE, "agent");
            if (lane == 0) flag[0] = dead ? 1u : 0u;
        }
        asm volatile("s_waitcnt vmcnt(0) lgkmcnt(0)" ::: "memory"); __builtin_amdgcn_s_barrier(); asm volatile("" ::: "memory");
        const bool bad = flag[0] != 0u;
        if (lane < 32) {
            const unsigned long long* slot = (const unsigned long long*)xbuf + (size_t)(u.pm * BM + row) * 4; float mt[4], m2[4]; float ms = 0.f;
#pragma unroll
            for (int t = 0; t < 4; ++t) { if (t < ntn) { const unsigned long long w = __hip_atomic_load(slot + t, __ATOMIC_RELAXED, __HIP_MEMORY_SCOPE_AGENT); mt[t] = __uint_as_float((unsigned)w); m2[t] = __uint_as_float((unsigned)(w >> 32)); } else { mt[t] = 0.f; m2[t] = 0.f; } ms += mt[t]; }
            const float mean = ms / (float)ntn; float q = 0.f;
#pragma unroll
            for (int t = 0; t < 4; ++t) if (t < ntn) { const float dm = mt[t] - mean; q += m2[t] + 256.0f * dm * dm; }
            S[row] = (f32x2v){mean, 1.0f / sqrtf(q / (256.0f * (float)ntn) + eps)};
        }
        asm volatile("s_waitcnt lgkmcnt(0)" ::: "memory"); __builtin_amdgcn_s_barrier(); asm volatile("" ::: "memory");
        return bad;
    }
};
struct EpiLnRes {
    static constexpr bool PERM = false, AFTER_DRAIN = true, HAS_MID = false;
    const float* base; float* out; int ldc; const float* bias; PanelStats st; unsigned poison;
    __device__ __forceinline__ void fused(f32x4 (&acc)[2][2][4][2], const Unit& u, int wr, int wc, int fr, int fq, PG8_LAS unsigned char* lds, int wid, int lane) const {
        typedef float f32x2v __attribute__((ext_vector_type(2)));
        const PG8_LAS f32x2v* S = (const PG8_LAS f32x2v*)(lds + 8192);
        const int col0 = u.pn * BM + wc * 32 + 4 * fq;
#pragma unroll
        for (int bj = 0; bj < 2; ++bj)
#pragma unroll
            for (int n = 0; n < 2; ++n) { const f32x4 bv = bias ? *(const f32x4*)(bias + col0 + bj * HALF + n * 16) : (f32x4){0.f, 0.f, 0.f, 0.f};
#pragma unroll
                for (int ai = 0; ai < 2; ++ai)
#pragma unroll
                    for (int m = 0; m < 4; ++m) acc[ai][bj][m][n] += bv; }
        f32x4 pre[4][2][2];
#pragma unroll
        for (int m = 0; m < 4; ++m) { const size_t off = (size_t)(u.pm * BM + wr * 64 + m * 16 + fr) * ldc + col0;
#pragma unroll
            for (int bj = 0; bj < 2; ++bj)
#pragma unroll
                for (int n = 0; n < 2; ++n) pre[m][bj][n] = *(const f32x4*)(base + off + bj * HALF + n * 16); }
        const bool bad = st.run(acc, u, wr, wc, fr, fq, lds, wid, lane) || poison != 0u;
        const float qnan = __builtin_nanf("");
#pragma unroll
        for (int ai = 0; ai < 2; ++ai)
#pragma unroll
            for (int m = 0; m < 4; ++m) { const int r = ai * HALF + wr * 64 + m * 16 + fr; const f32x2v sr = S[r]; const size_t off = (size_t)(u.pm * BM + r) * ldc + col0;
#pragma unroll
                for (int bj = 0; bj < 2; ++bj)
#pragma unroll
                    for (int n = 0; n < 2; ++n) { const f32x4 bs = ai == 0 ? pre[m][bj][n] : *(const f32x4*)(base + off + bj * HALF + n * 16); f32x4 o = bs + (acc[ai][bj][m][n] - sr.x) * sr.y;
                        if (bad) o = (f32x4){qnan, qnan, qnan, qnan}; *(f32x4*)(out + off + bj * HALF + n * 16) = o; }
                if (m & 1) asm volatile("" ::: "memory"); }
    }
};
struct EpiLnResLn {
    static constexpr bool PERM = false, AFTER_DRAIN = true, HAS_MID = false;
    const float* base; float* out; bf16_t* xn; int ldc; const float* bias; PanelStats st1, st2; unsigned poison;
    __device__ __forceinline__ void fused(f32x4 (&acc)[2][2][4][2], const Unit& u, int wr, int wc, int fr, int fq, PG8_LAS unsigned char* lds, int wid, int lane) const {
        typedef float f32x2v __attribute__((ext_vector_type(2))); typedef unsigned u32x2v __attribute__((ext_vector_type(2)));
        const PG8_LAS f32x2v* S = (const PG8_LAS f32x2v*)(lds + 8192);
        const int col0 = u.pn * BM + wc * 32 + 4 * fq;
#pragma unroll
        for (int bj = 0; bj < 2; ++bj)
#pragma unroll
            for (int n = 0; n < 2; ++n) { const f32x4 bv = bias ? *(const f32x4*)(bias + col0 + bj * HALF + n * 16) : (f32x4){0.f, 0.f, 0.f, 0.f};
#pragma unroll
                for (int ai = 0; ai < 2; ++ai)
#pragma unroll
                    for (int m = 0; m < 4; ++m) acc[ai][bj][m][n] += bv; }
        bool bad = st1.run(acc, u, wr, wc, fr, fq, lds, wid, lane) || poison != 0u;
        const float qnan = __builtin_nanf("");
#pragma unroll
        for (int ai = 0; ai < 2; ++ai)
#pragma unroll
            for (int m = 0; m < 4; ++m) { const int r = ai * HALF + wr * 64 + m * 16 + fr; const f32x2v sr = S[r]; const size_t off = (size_t)(u.pm * BM + r) * ldc + col0;
#pragma unroll
                for (int bj = 0; bj < 2; ++bj)
#pragma unroll
                    for (int n = 0; n < 2; ++n) { const f32x4 bs = *(const f32x4*)(base + off + bj * HALF + n * 16); acc[ai][bj][m][n] = bs + (acc[ai][bj][m][n] - sr.x) * sr.y; }
                asm volatile("" : "+v"(acc[ai][0][m][0]), "+v"(acc[ai][0][m][1]), "+v"(acc[ai][1][m][0]), "+v"(acc[ai][1][m][1]));
                if (m & 1) asm volatile("" ::: "memory"); }
        const bool bad1 = bad;
        bad = st2.run(acc, u, wr, wc, fr, fq, lds, wid, lane) || bad;
#pragma unroll
        for (int ai = 0; ai < 2; ++ai)
#pragma unroll
            for (int m = 0; m < 4; ++m) { const int r = ai * HALF + wr * 64 + m * 16 + fr; const f32x2v sr = S[r]; const size_t off = (size_t)(u.pm * BM + r) * ldc + col0;
#pragma unroll
                for (int bj = 0; bj < 2; ++bj)
#pragma unroll
                    for (int n = 0; n < 2; ++n) { const f32x4 x1 = acc[ai][bj][m][n]; *(f32x4*)(out + off + bj * HALF + n * 16) = bad1 ? (f32x4){qnan, qnan, qnan, qnan} : x1;
                        const f32x4 o = (x1 - sr.x) * sr.y; u32x2v w; w.x = cvt_pk_bf16(o[0], o[1]); w.y = cvt_pk_bf16(o[2], o[3]);
                        if (bad) { w.x = 0x7fc07fc0u; w.y = 0x7fc07fc0u; } *(u32x2v*)(xn + off + bj * HALF + n * 16) = w; }
                asm volatile("" ::: "memory"); }
    }
};

template <class Epi, class Sched, bool ALIGN_EPI = false, bool SP2 = false>
__device__ __forceinline__ void gemm_phase(PG8_LAS unsigned char* lds, const Gemm g, const Sched& S, const Epi& E) {
    const int tid = threadIdx.x, wid = __builtin_amdgcn_readfirstlane(tid >> 6), lane = tid & 63, wr = wid >> 2, wc = wid & 3, fr = lane & 15, fq = lane >> 4;
    const int K = g.K, nt = K / BK;
    unsigned voffA[2], voffB[2];
#pragma unroll
    for (int i = 0; i < 2; ++i) { int R, C; stage_rc(tid * 16 + i * 8192, R, C); const int Rb = Epi::PERM ? ((R & ~31) + perm32(R & 31)) : R;
        voffA[i] = (unsigned)(R * K + C) * 2u; voffB[i] = (unsigned)(Rb * K + C) * 2u; }
    const size_t kstep = (size_t)(BK * 2);
    const size_t hstep = (size_t)HALF * K * 2;
    const size_t tstep = 2 * hstep;
    const unsigned ldsw = (unsigned)wid * 1024u;
    const int aoff = lds_byte(wr * 64 + fr, fq * 8), boff = lds_byte(wc * 32 + fr, fq * 8);
#define PG8_SA(b, h) (((b) * 2 + (h)) * HTB)
#define PG8_SB(b, h) ((4 + (b) * 2 + (h)) * HTB)
#define PG8_STAGE(bufoff, gbase, voff) do { _Pragma("unroll") for (int _i = 0; _i < 2; ++_i) \
        __builtin_amdgcn_global_load_lds((const unsigned*)((const char*)(gbase) + (voff)[_i]), (PG8_LAS unsigned*)(lds + (bufoff) + ldsw + _i * 8192), 16, 0, 0); } while (0)
#define PG8_LDA(dst, b, h) do { _Pragma("unroll") for (int m = 0; m < 4; ++m) _Pragma("unroll") for (int k = 0; k < 2; ++k) dst[m][k] = *(const PG8_LAS bf16x8*)(lds + PG8_SA(b, h) + aoff + m * 2048 + k * 1024); } while (0)
#define PG8_LDB(dst, b, h) do { _Pragma("unroll") for (int n = 0; n < 2; ++n) _Pragma("unroll") for (int k = 0; k < 2; ++k) dst[n][k] = *(const PG8_LAS bf16x8*)(lds + PG8_SB(b, h) + boff + n * 2048 + k * 1024); } while (0)
#define PG8_MMA(ai, bj, At, Bt) do { __builtin_amdgcn_s_setprio(1); _Pragma("unroll") for (int m = 0; m < 4; ++m) _Pragma("unroll") for (int n = 0; n < 2; ++n) _Pragma("unroll") for (int k = 0; k < 2; ++k) \
        acc[ai][bj][m][n] = __builtin_amdgcn_mfma_f32_16x16x32_bf16(Bt[n][k], At[m][k], acc[ai][bj][m][n], 0, 0, 0); __builtin_amdgcn_s_setprio(0); } while (0)
#define PG8_WAIT_V(n) asm volatile("s_waitcnt vmcnt(" #n ")" ::: "memory")
#define PG8_WAIT_L(n) asm volatile("s_waitcnt lgkmcnt(" #n ")" ::: "memory")
#define PG8_BAR __builtin_amdgcn_s_barrier()
#define PG8_SCHED __builtin_amdgcn_sched_barrier(0)
    Unit cur, nxt; int ui = 0;
    if (!S.next(0, cur)) return;
    f32x4 acc[2][2][4][2];
#pragma unroll
    for (int a = 0; a < 2; ++a)
#pragma unroll
        for (int b = 0; b < 2; ++b)
#pragma unroll
            for (int m = 0; m < 4; ++m)
#pragma unroll
                for (int n = 0; n < 2; ++n) acc[a][b][m][n] = (f32x4){0.f, 0.f, 0.f, 0.f};
    bf16x8 At[4][2], B0[2][2], B1[2][2];
    const char* cA = (const char*)g.A + (size_t)cur.pm * tstep; const char* cB = (const char*)g.Bt + (size_t)cur.pn * tstep;
    S.a_ready(cur);
    if constexpr (SP2) {
        PG8_STAGE(PG8_SB(0, 0), cB, voffB); PG8_STAGE(PG8_SB(0, 1), cB + hstep, voffB); PG8_STAGE(PG8_SA(0, 0), cA, voffA); PG8_STAGE(PG8_SA(0, 1), cA + hstep, voffA);
        if (wr == 1) PG8_BAR;
        PG8_WAIT_V(2); PG8_BAR;
        PG8_STAGE(PG8_SB(1, 0), cB + kstep, voffB); PG8_STAGE(PG8_SA(1, 0), cA + kstep, voffA); PG8_STAGE(PG8_SB(1, 1), cB + hstep + kstep, voffB);
        PG8_WAIT_V(6); PG8_BAR;
    } else {
        PG8_STAGE(PG8_SB(0, 0), cB, voffB); PG8_STAGE(PG8_SA(0, 0), cA, voffA); PG8_STAGE(PG8_SB(0, 1), cB + hstep, voffB); PG8_STAGE(PG8_SA(0, 1), cA + hstep, voffA);
        if (wr == 1) PG8_BAR;
        PG8_WAIT_V(4); PG8_BAR;
        PG8_STAGE(PG8_SB(1, 0), cB + kstep, voffB); PG8_STAGE(PG8_SA(1, 0), cA + kstep, voffA); PG8_STAGE(PG8_SB(1, 1), cB + hstep + kstep, voffB);
        PG8_WAIT_V(6); PG8_BAR;
    }
    for (;;) {
        const bool has_next = S.next(ui + 1, nxt);
        const char* nA = has_next ? (const char*)g.A + (size_t)nxt.pm * tstep : cA; const char* nB = has_next ? (const char*)g.Bt + (size_t)nxt.pn * tstep : cB;
        for (int seg = 0; seg < (Epi::HAS_MID ? 2 : 1); ++seg) {
        if constexpr (Epi::HAS_MID) { if (seg == 1) E.mid(acc, cur, wr, wc, fr, fq); }
        const int tseg = Epi::HAS_MID ? (nt >> 1) : nt;
        for (int t = seg * tseg; t < (seg + 1) * tseg; t += 2) {
            const bool last = (t == nt - 2);
            const char* a1 = cA + (size_t)(t + 1) * kstep;
            const char* a2 = last ? nA : cA + (size_t)(t + 2) * kstep; const char* b2 = last ? nB : cB + (size_t)(t + 2) * kstep;
            const char* a3 = a2 + kstep; const char* b3 = b2 + kstep;
            if (last && has_next) S.a_ready(nxt);
            if constexpr (SP2) {
            PG8_LDB(B0, 0, 0); PG8_LDB(B1, 0, 1); PG8_SCHED; PG8_LDA(At, 0, 0); PG8_STAGE(PG8_SA(1, 1), a1 + hstep, voffA);
            PG8_WAIT_V(8); PG8_WAIT_L(0); PG8_BAR; PG8_MMA(0, 0, At, B0); PG8_MMA(0, 1, At, B1); PG8_BAR; PG8_SCHED;
            PG8_LDA(At, 0, 1); PG8_STAGE(PG8_SB(0, 0), b2, voffB); PG8_STAGE(PG8_SB(0, 1), b2 + hstep, voffB); PG8_STAGE(PG8_SA(0, 0), a2, voffA);
            PG8_WAIT_V(8); PG8_WAIT_L(0); PG8_BAR; PG8_MMA(1, 0, At, B0); PG8_MMA(1, 1, At, B1); PG8_BAR; PG8_SCHED;
            PG8_LDB(B0, 1, 0); PG8_LDB(B1, 1, 1); PG8_SCHED; PG8_LDA(At, 1, 0); PG8_STAGE(PG8_SA(0, 1), a2 + hstep, voffA);
            PG8_WAIT_V(8); PG8_WAIT_L(0); PG8_BAR; PG8_MMA(0, 0, At, B0); PG8_MMA(0, 1, At, B1); PG8_BAR; PG8_SCHED;
            PG8_LDA(At, 1, 1); PG8_STAGE(PG8_SB(1, 0), b3, voffB); PG8_STAGE(PG8_SB(1, 1), b3 + hstep, voffB); PG8_STAGE(PG8_SA(1, 0), a3, voffA);
            PG8_WAIT_V(8); PG8_WAIT_L(0); PG8_BAR; PG8_MMA(1, 0, At, B0); PG8_MMA(1, 1, At, B1); PG8_BAR; PG8_SCHED;
            } else {
            PG8_LDB(B0, 0, 0); PG8_SCHED; PG8_LDA(At, 0, 0); PG8_STAGE(PG8_SA(1, 1), a1 + hstep, voffA);
            PG8_WAIT_L(8); PG8_BAR; PG8_WAIT_L(0); PG8_MMA(0, 0, At, B0); PG8_BAR; PG8_SCHED;
            PG8_LDB(B1, 0, 1); PG8_STAGE(PG8_SB(0, 0), b2, voffB);
            PG8_BAR; PG8_WAIT_L(0); PG8_MMA(0, 1, At, B1); PG8_BAR;
            PG8_LDA(At, 0, 1); PG8_STAGE(PG8_SA(0, 0), a2, voffA);
            PG8_BAR; PG8_WAIT_L(0); PG8_MMA(1, 0, At, B0); PG8_BAR; PG8_SCHED;
            PG8_STAGE(PG8_SB(0, 1), b2 + hstep, voffB);
            PG8_WAIT_V(6); PG8_BAR; PG8_MMA(1, 1, At, B1); PG8_BAR;
            PG8_LDB(B0, 1, 0); PG8_SCHED; PG8_LDA(At, 1, 0); PG8_STAGE(PG8_SA(0, 1), a2 + hstep, voffA);
            PG8_WAIT_L(8); PG8_BAR; PG8_WAIT_L(0); PG8_MMA(0, 0, At, B0); PG8_BAR; PG8_SCHED;
            PG8_LDB(B1, 1, 1); PG8_STAGE(PG8_SB(1, 0), b3, voffB);
            PG8_BAR; PG8_WAIT_L(0); PG8_MMA(0, 1, At, B1); PG8_BAR;
            PG8_LDA(At, 1, 1); PG8_STAGE(PG8_SA(1, 0), a3, voffA);
            PG8_BAR; PG8_WAIT_L(0); PG8_MMA(1, 0, At, B0); PG8_BAR; PG8_SCHED;
            PG8_STAGE(PG8_SB(1, 1), b3 + hstep, voffB);
            PG8_WAIT_V(6); PG8_BAR; PG8_MMA(1, 1, At, B1); PG8_BAR;
            }
        }
        }
        if constexpr (ALIGN_EPI) { if (wr == 0) PG8_BAR; }
        if constexpr (!Epi::AFTER_DRAIN) { E(acc, cur, wr, wc, fr, fq); S.done(cur); }
        if (!has_next) break;
#pragma unroll
        for (int a = 0; a < 2; ++a)
#pragma unroll
            for (int b = 0; b < 2; ++b)
#pragma unroll
                for (int m = 0; m < 4; ++m)
#pragma unroll
                    for (int n = 0; n < 2; ++n) acc[a][b][m][n] = (f32x4){0.f, 0.f, 0.f, 0.f};
        cur = nxt; cA = nA; cB = nB; ++ui;
        if constexpr (ALIGN_EPI) { if (wr == 1) PG8_BAR; }
    }
    PG8_WAIT_V(0);
    if constexpr (!ALIGN_EPI) { if (wr == 0) PG8_BAR; }
    PG8_BAR;
    if constexpr (Epi::AFTER_DRAIN) { E.fused(acc, cur, wr, wc, fr, fq, lds, wid, lane); S.done(cur); }
#undef PG8_SA
#undef PG8_SB
#undef PG8_STAGE
#undef PG8_LDA
#undef PG8_LDB
#undef PG8_MMA
#undef PG8_WAIT_V
#undef PG8_WAIT_L
#undef PG8_BAR
#undef PG8_SCHED
}
}

namespace mk {
using pg8::f32x4; using pg8::u32x4; using pg8::bf16_t; using pg8::Unit; using pg8::BM; using pg8::HALF; using pg8::cvt_pk_bf16;
constexpr int D_MODEL = 1024, IN_COLS = 3840, D_FF = 2816;
constexpr int O_K = 512, O_V = 640, O_CA = 768, O_CB = 1280, O_GA = 1792, O_GC = 2816;
constexpr float ALPHA = 1.189207115002721f;
constexpr float LOG2E = 1.4426950408889634f;
__device__ __forceinline__ float bf_lo(unsigned w) { return __uint_as_float(w << 16); }
__device__ __forceinline__ float bf_hi(unsigned w) { return __uint_as_float(w & 0xffff0000u); }
__device__ __forceinline__ float expneg(float x) { return __builtin_amdgcn_exp2f(-LOG2E * __builtin_fminf(__builtin_fmaxf(x, -30.f), 30.f)); }
__device__ __forceinline__ float sigm(float x) { return __builtin_amdgcn_rcpf(1.0f + expneg(x)); }

struct EpiMerge {
    static constexpr bool PERM = true, AFTER_DRAIN = false, HAS_MID = true;
    const bf16_t* U; bf16_t* O;
    __device__ __forceinline__ void mid(f32x4 (&acc)[2][2][4][2], const Unit& u, int wr, int wc, int fr, int fq) const {
        int row0 = u.pm * BM + wr * 64 + fr; const int col0 = u.pn * BM + wc * 32 + 8 * fq;
        asm volatile("" : "+v"(row0));
#pragma unroll
        for (int ai = 0; ai < 2; ++ai)
#pragma unroll
            for (int m = 0; m < 4; ++m) { const bf16_t* rp = U + ((unsigned)(row0 + ai * HALF + m * 16) * (unsigned)IN_COLS + (unsigned)col0);
#pragma unroll
                for (int bj = 0; bj < 2; ++bj) { const u32x4 a = *(const u32x4*)(rp + O_GA + bj * HALF), c = *(const u32x4*)(rp + O_GC + bj * HALF);
#define MK_RATIO(wa, wc_, f) ((1.0f + expneg(f(wc_))) * __builtin_amdgcn_rcpf(1.0f + expneg(f(wa))))
                    f32x4 r0, r1;
                    r0[0] = MK_RATIO(a.x, c.x, bf_lo); r0[1] = MK_RATIO(a.x, c.x, bf_hi); r0[2] = MK_RATIO(a.y, c.y, bf_lo); r0[3] = MK_RATIO(a.y, c.y, bf_hi);
                    r1[0] = MK_RATIO(a.z, c.z, bf_lo); r1[1] = MK_RATIO(a.z, c.z, bf_hi); r1[2] = MK_RATIO(a.w, c.w, bf_lo); r1[3] = MK_RATIO(a.w, c.w, bf_hi);
#undef MK_RATIO
                    acc[ai][bj][m][0] = acc[ai][bj][m][0] * r0; acc[ai][bj][m][1] = acc[ai][bj][m][1] * r1; }
                asm volatile("" ::: "memory"); }
    }
    __device__ __forceinline__ void operator()(const f32x4 (&acc)[2][2][4][2], const Unit& u, int wr, int wc, int fr, int fq) const {
        int row0 = u.pm * BM + wr * 64 + fr; const int col0 = u.pn * BM + wc * 32 + 8 * fq;
        asm volatile("" : "+v"(row0));
#pragma unroll
        for (int ai = 0; ai < 2; ++ai)
#pragma unroll
            for (int m = 0; m < 4; ++m) { const unsigned row = (unsigned)(row0 + ai * HALF + m * 16); const bf16_t* rp = U + (row * (unsigned)IN_COLS + (unsigned)col0); bf16_t* op = O + (row * (unsigned)D_MODEL + (unsigned)col0);
#pragma unroll
                for (int bj = 0; bj < 2; ++bj) { const u32x4 c = *(const u32x4*)(rp + O_GC + bj * HALF);
                    f32x4 v0 = acc[ai][bj][m][0], v1 = acc[ai][bj][m][1];
                    v0[0] *= sigm(bf_lo(c.x)); v0[1] *= sigm(bf_hi(c.x)); v0[2] *= sigm(bf_lo(c.y)); v0[3] *= sigm(bf_hi(c.y));
                    v1[0] *= sigm(bf_lo(c.z)); v1[1] *= sigm(bf_hi(c.z)); v1[2] *= sigm(bf_lo(c.w)); v1[3] *= sigm(bf_hi(c.w));
                    u32x4 w; w.x = cvt_pk_bf16(v0[0], v0[1]); w.y = cvt_pk_bf16(v0[2], v0[3]); w.z = cvt_pk_bf16(v1[0], v1[1]); w.w = cvt_pk_bf16(v1[2], v1[3]);
                    *(u32x4*)(op + bj * HALF) = w; }
                asm volatile("" ::: "memory"); }
    }
};

struct EpiSwiGLU {
    static constexpr bool PERM = true, AFTER_DRAIN = false, HAS_MID = false;
    bf16_t* O;
    __device__ __forceinline__ void operator()(const f32x4 (&acc)[2][2][4][2], const Unit& u, int wr, int wc, int fr, int fq) const {
        const int row0 = u.pm * BM + wr * 64 + fr, col0 = u.pn * HALF + wc * 32 + 8 * fq;
#pragma unroll
        for (int ai = 0; ai < 2; ++ai)
#pragma unroll
            for (int m = 0; m < 4; ++m) { bf16_t* op = O + (size_t)(row0 + ai * HALF + m * 16) * D_FF + col0;
                f32x4 h0, h1;
#pragma unroll
                for (int e = 0; e < 4; ++e) { const float g0 = acc[ai][0][m][0][e], g1 = acc[ai][0][m][1][e];
                    h0[e] = g0 * sigm(g0) * acc[ai][1][m][0][e]; h1[e] = g1 * sigm(g1) * acc[ai][1][m][1][e]; }
                u32x4 w; w.x = cvt_pk_bf16(h0[0], h0[1]); w.y = cvt_pk_bf16(h0[2], h0[3]); w.z = cvt_pk_bf16(h1[0], h1[1]); w.w = cvt_pk_bf16(h1[2], h1[3]);
                *(u32x4*)op = w; }
    }
};

template <int MODE> struct EpiResid {
    static constexpr bool PERM = false, AFTER_DRAIN = false, HAS_MID = false;
    const float* x; const float* stats; const float* g; const float* b; float* out;
    __device__ __forceinline__ void operator()(const f32x4 (&acc)[2][2][4][2], const Unit& u, int wr, int wc, int fr, int fq) const {
        typedef float f32x2v __attribute__((ext_vector_type(2)));
        const int row0 = u.pm * BM + wr * 64 + fr, col0 = u.pn * BM + wc * 32 + 4 * fq;
        f32x2v st[2][4];
        if (MODE == 0) {
#pragma unroll
            for (int ai = 0; ai < 2; ++ai)
#pragma unroll
                for (int m = 0; m < 4; ++m) st[ai][m] = *(const f32x2v*)(stats + 2 * (size_t)(row0 + ai * HALF + m * 16));
        }
#pragma unroll
        for (int bj = 0; bj < 2; ++bj)
#pragma unroll
            for (int n = 0; n < 2; ++n) { const int c = col0 + bj * HALF + n * 16;
                f32x4 gv = {1.f, 1.f, 1.f, 1.f}, bv = {0.f, 0.f, 0.f, 0.f};
                if (MODE == 0) { gv = *(const f32x4*)(g + c); bv = *(const f32x4*)(b + c); }
#pragma unroll
                for (int ai = 0; ai < 2; ++ai)
#pragma unroll
                    for (int m = 0; m < 4; ++m) { const size_t off = (size_t)(row0 + ai * HALF + m * 16) * D_MODEL + c;
                        f32x4 r;
                        if (MODE == 0) { const f32x4 xv = *(const f32x4*)(x + off); r = (xv - st[ai][m].x) * st[ai][m].y * gv + bv; }
                        else r = *(const f32x4*)(out + off);
                        *(f32x4*)(out + off) = r * ALPHA + acc[ai][bj][m][n]; } }
    }
};
}
#define GAS __attribute__((address_space(1)))
#define LAS __attribute__((address_space(3)))
typedef unsigned short bf16;
typedef unsigned v4u __attribute__((ext_vector_type(4)));
typedef float f32x4 __attribute__((ext_vector_type(4)));
typedef short bf16x8 __attribute__((ext_vector_type(8)));
typedef GAS unsigned gu32;
typedef GAS unsigned long long gu64;
#define RLX_AGENT __ATOMIC_RELAXED, __HIP_MEMORY_SCOPE_AGENT
#define LDS_WAIT() asm volatile("s_waitcnt lgkmcnt(0)" ::: "memory")
#define VM_WAIT() asm volatile("s_waitcnt vmcnt(0)" ::: "memory")
__device__ __forceinline__ unsigned long long rt() { return __builtin_amdgcn_s_memrealtime(); }
__device__ __forceinline__ unsigned f2bf(float f) { unsigned u = __builtin_bit_cast(unsigned, f); return (u + 0x7fffu + ((u >> 16) & 1u)) >> 16; }
__device__ __forceinline__ unsigned pk2(float lo, float hi) { return f2bf(lo) | (f2bf(hi) << 16); }

#define XB_TMO      128
#define XB_XCNT(j)  (256  + 64 * (j))
#define XB_XSUB(j)  (1280 + 64 * (j))
#define XB_XGEN(j)  (2304 + 64 * (j))
#define XB_TOP      3328
#define XB_TOPGEN   3392
#define XCD_BAR_WORDS 3456
#define XB_SPIN_CAP (1u << 18)

__device__ __forceinline__ unsigned xb_ld(unsigned* p)              { return __hip_atomic_load(p, __ATOMIC_RELAXED, __HIP_MEMORY_SCOPE_AGENT); }
__device__ __forceinline__ unsigned xb_add(unsigned* p, unsigned v) { return __hip_atomic_fetch_add(p, v, __ATOMIC_RELAXED, __HIP_MEMORY_SCOPE_AGENT); }
__device__ __forceinline__ unsigned xb_xcc_id() { return (unsigned)__builtin_amdgcn_s_getreg((3 << 11) | 20) & 0xFu; }
#define XB_SPIN(cond, bar) do { unsigned _sp = 0; while (cond) { __builtin_amdgcn_s_sleep(1); \
    if ((++_sp & 255u) == 0u) { if (xb_ld(&(bar)[XB_TMO])) break; if (_sp > XB_SPIN_CAP) { atomicAdd(&(bar)[XB_TMO], 1u); break; } } } } while (0)

struct XcdBarrier {
    unsigned* bar; unsigned x;
    volatile LAS unsigned* st;
};

__device__ __forceinline__ XcdBarrier xcd_barrier_post(unsigned* bar, volatile LAS unsigned* st) {
    XcdBarrier b; b.bar = bar; b.x = xb_xcc_id(); b.st = st;
    if (threadIdx.x == 0) (void)xb_add(&bar[XB_XCNT(b.x)], 1u);
    return b;
}
__device__ __forceinline__ void xcd_barrier_complete(unsigned* bar, unsigned x, unsigned& nloc, unsigned& nx) {
    const unsigned G = gridDim.x * gridDim.y * gridDim.z;
    unsigned sum, cnt, mine, sp = 0u;
    for (;;) {
        sum = 0u; cnt = 0u; mine = 0u;
#pragma unroll
        for (unsigned j = 0; j < 16; ++j) { const unsigned c = xb_ld(&bar[XB_XCNT(j)]); sum += c; cnt += (c > 0u) ? 1u : 0u; mine = (j == x) ? c : mine; }
        if (sum == G) break;
        __builtin_amdgcn_s_sleep(1);
        if ((++sp & 255u) == 0u) { if (xb_ld(&bar[XB_TMO])) break; if (sp > XB_SPIN_CAP) { atomicAdd(&bar[XB_TMO], 1u); break; } }
    }
    nloc = mine > 0u ? mine : 1u; nx = cnt > 0u ? cnt : 1u;
}

__device__ __forceinline__ void xcd_barrier(const XcdBarrier& b) {
    asm volatile("s_waitcnt vmcnt(0)" ::: "memory");
    __syncthreads();
    if (threadIdx.x == 0) {
        unsigned* bar = b.bar;
        __builtin_amdgcn_s_waitcnt(0);
        unsigned nloc = b.st[0], nx = b.st[1];
        if (nloc == 0u) { xcd_barrier_complete(bar, b.x, nloc, nx); b.st[0] = nloc; b.st[1] = nx; }
        const unsigned old = xb_add(&bar[XB_XSUB(b.x)], 1u);
        const unsigned gen = old / nloc;
        if (old + 1u == (gen + 1u) * nloc) {
            __builtin_amdgcn_fence(__ATOMIC_RELEASE, "agent");
            asm volatile("s_waitcnt vmcnt(0)" ::: "memory");
            const unsigned og = xb_add(&bar[XB_TOP], 1u);
            const unsigned tg = og / nx;
            if (og + 1u == (tg + 1u) * nx) xb_add(&bar[XB_TOPGEN], 1u);
            else XB_SPIN(xb_ld(&bar[XB_TOPGEN]) == tg, bar);
            __builtin_amdgcn_fence(__ATOMIC_ACQUIRE, "agent");
            xb_add(&bar[XB_XGEN(b.x)], 1u);
            asm volatile("s_waitcnt vmcnt(0)" ::: "memory");
        } else {
            XB_SPIN(xb_ld(&bar[XB_XGEN(b.x)]) == gen, bar);
            __builtin_amdgcn_fence(__ATOMIC_ACQUIRE, "agent");
            asm volatile("s_waitcnt vmcnt(0)" ::: "memory");
        }
    }
    __syncthreads();
}

constexpr int NWAVES = 8;
#ifndef MK_N_LAUNCHES
#define MK_N_LAUNCHES 1
#endif
constexpr int N_PHASES = 9;
constexpr int N_LAUNCHES = MK_N_LAUNCHES;
static_assert(N_LAUNCHES == 1 || N_LAUNCHES == N_PHASES, "MK_N_LAUNCHES is 1 or N_PHASES");

constexpr int BATCH = 8, SEQ = 2048, D = 1024, M = BATCH * SEQ;
constexpr int IN_COLS = mk::IN_COLS, D_FF = mk::D_FF, NGU = 2 * D_FF;
constexpr float LN_EPS = 1e-5f;
constexpr float C2 = 0.125f * 1.4426950408889634f;

constexpr size_t MiB = 1u << 20;
constexpr size_t WS_CTL = 0, CTL_ZERO_BYTES = 1 * MiB;
constexpr size_t WS_WIN = 2 * MiB;
constexpr size_t WS_WAC = 10 * MiB;
constexpr size_t WS_WOUT = 12 * MiB;
constexpr size_t WS_WGU = 14 * MiB;
constexpr size_t WS_WD = 25 * MiB;
constexpr size_t WS_STATS = 31 * MiB;
constexpr size_t WS_BIASIN = 31 * MiB + 512 * 1024;
constexpr size_t WS_XN = 32 * MiB;
constexpr size_t WS_MERGED = 32 * MiB;
constexpr size_t WS_U = 64 * MiB;
constexpr size_t WS_HID = 64 * MiB;
constexpr size_t WS_OC = 184 * MiB;
constexpr size_t WS_HN = 216 * MiB;
constexpr size_t WS_END = 248 * MiB;
static_assert(WS_WIN + (size_t)IN_COLS * D * 2 <= WS_WAC && WS_WGU + (size_t)NGU * D * 2 <= WS_WD && WS_WD + (size_t)D * D_FF * 2 <= WS_STATS, "weights map");
static_assert(WS_U + (size_t)M * IN_COLS * 2 <= WS_OC && WS_HID + (size_t)M * D_FF * 2 <= WS_OC && WS_HN + (size_t)M * D * 2 <= WS_END, "activation map");
constexpr int CW_BAR = 4096;

constexpr int RING_OFF = 0, RING_BYTES = 131072;
constexpr int LDSCTL_OFF = RING_BYTES, MISC_OFF = LDSCTL_OFF + 320;
constexpr int LDS_BYTES = 147456;
static_assert(MISC_OFF + 128 <= LDS_BYTES, "LDS map");

struct Frame {
    LAS unsigned char* lds;
    volatile LAS unsigned* MISC;
    gu32* ctl;
    int tid, lane, wave;
    int vcu, G;
};

__device__ __forceinline__ float wave_sum(float v) {
#pragma unroll
    for (int o = 1; o < 64; o <<= 1) v += __shfl_xor(v, o);
    return v;
}
__device__ __forceinline__ void p0_transpose_item(const float* W, int N, bf16* WT, int ldk, int k0, int n0, int orow, int kcol, LAS float* scr, int lane) {
#pragma unroll 8
    for (int i = 0; i < 32; ++i) { const int kk = 2 * i + (lane >> 5); scr[kk * 33 + (lane & 31)] = W[(size_t)(k0 + kk) * N + n0 + (lane & 31)]; }
    LDS_WAIT(); asm volatile("" ::: "memory");
    const int c = lane & 7;
#pragma unroll
    for (int j = 0; j < 4; ++j) { const int n = (lane >> 3) + 8 * j; const LAS float* s = scr + (8 * c) * 33 + n;
        v4u o; o.x = pk2(s[0 * 33], s[1 * 33]); o.y = pk2(s[2 * 33], s[3 * 33]); o.z = pk2(s[4 * 33], s[5 * 33]); o.w = pk2(s[6 * 33], s[7 * 33]);
        *(GAS v4u*)(WT + (size_t)(orow + n) * ldk + kcol + k0 + 8 * c) = o; }
    LDS_WAIT(); asm volatile("" ::: "memory");
}
struct In {
    const float *x, *ln_in_g, *ln_in_b, *rel_bias, *w_in, *b_gate, *conv_w, *conv_b, *conv_ln_g, *conv_ln_b, *w_conv_out, *w_attn_out, *sink, *w_out, *ln1_g, *ln1_b, *w_gate, *w_up, *w_down, *ln2_g, *ln2_b;
};
struct Args { const float* in[21]; float* out; unsigned char* ws; int ph_lo, ph_hi; };

__device__ __forceinline__ void ln_in_row(const float* xrow, const float* g, const float* b, bf16* orow, float* st, int lane) {
    const GAS f32x4* xr = (const GAS f32x4*)xrow + lane;
    f32x4 v[4]; float s = 0.f;
#pragma unroll
    for (int j = 0; j < 4; ++j) { v[j] = xr[64 * j]; s += (v[j].x + v[j].y) + (v[j].z + v[j].w); }
    const float mean = wave_sum(s) * (1.f / D); float s2 = 0.f;
#pragma unroll
    for (int j = 0; j < 4; ++j) { v[j] = v[j] - mean; s2 += (v[j].x * v[j].x + v[j].y * v[j].y) + (v[j].z * v[j].z + v[j].w * v[j].w); }
    const float rstd = 1.f / sqrtf(wave_sum(s2) * (1.f / D) + LN_EPS);
    if (lane == 0) { st[0] = mean; st[1] = rstd; }
    GAS unsigned long long* o8 = (GAS unsigned long long*)orow + lane;
#pragma unroll
    for (int j = 0; j < 4; ++j) { const f32x4 gg = ((const GAS f32x4*)g)[lane + 64 * j], bb = ((const GAS f32x4*)b)[lane + 64 * j]; const f32x4 y = v[j] * rstd * gg + bb;
        o8[64 * j] = (unsigned long long)pk2(y.x, y.y) | ((unsigned long long)pk2(y.z, y.w) << 32); }
}
__device__ __forceinline__ void ln_rows_pass(Frame& F, float* buf, const float* g, const float* b, bf16* hn) {
    const int gw = F.vcu * NWAVES + F.wave, NGW = F.G * NWAVES;
    for (int m = gw; m < M; m += NGW) {
        GAS f32x4* xr = (GAS f32x4*)(buf + (size_t)m * D) + F.lane;
        f32x4 v[4]; float s = 0.f;
#pragma unroll
        for (int j = 0; j < 4; ++j) { v[j] = xr[64 * j]; s += (v[j].x + v[j].y) + (v[j].z + v[j].w); }
        const float mean = wave_sum(s) * (1.f / D); float s2 = 0.f;
#pragma unroll
        for (int j = 0; j < 4; ++j) { v[j] = v[j] - mean; s2 += (v[j].x * v[j].x + v[j].y * v[j].y) + (v[j].z * v[j].z + v[j].w * v[j].w); }
        const float rstd = 1.f / sqrtf(wave_sum(s2) * (1.f / D) + LN_EPS);
#pragma unroll
        for (int j = 0; j < 4; ++j) { const f32x4 gg = ((const GAS f32x4*)g)[F.lane + 64 * j], bb = ((const GAS f32x4*)b)[F.lane + 64 * j]; const f32x4 y = v[j] * rstd * gg + bb;
            xr[64 * j] = y;
            if (hn) ((GAS unsigned long long*)(hn + (size_t)m * D) + F.lane)[64 * j] = (unsigned long long)pk2(y.x, y.y) | ((unsigned long long)pk2(y.z, y.w) << 32); }
    }
}

__device__ __forceinline__ void p0_prologue(Frame& F, const In& I, unsigned char* ws) {
    LAS float* scr = (LAS float*)(F.lds + RING_OFF + F.wave * 16384);
    const int gw = F.vcu * NWAVES + F.wave, NGW = F.G * NWAVES;
    bf16* Win_t = (bf16*)(ws + WS_WIN); bf16* Wac_t = (bf16*)(ws + WS_WAC); bf16* Wout_t = (bf16*)(ws + WS_WOUT); bf16* Wgu_t = (bf16*)(ws + WS_WGU); bf16* Wd_t = (bf16*)(ws + WS_WD);
    constexpr int I_IN = (D / 64) * (IN_COLS / 32), I_A = (512 / 64) * (D / 32), I_O = (D / 64) * (D / 32), I_G = (D / 64) * (D_FF / 32), I_D = (D_FF / 64) * (D / 32);
    constexpr int NITEMS = I_IN + 2 * I_A + I_O + 2 * I_G + I_D;
    for (int it = gw; it < NITEMS; it += NGW) {
        int r = it;
        if (r < I_IN) { const int nb = IN_COLS / 32, kb = r / nb, n0 = 32 * (r % nb); p0_transpose_item(I.w_in, IN_COLS, Win_t, D, 64 * kb, n0, n0, 0, scr, F.lane); continue; } r -= I_IN;
        if (r < I_A) { const int nb = D / 32, kb = r / nb, n0 = 32 * (r % nb); p0_transpose_item(I.w_attn_out, D, Wac_t, D, 64 * kb, n0, n0, 0, scr, F.lane); continue; } r -= I_A;
        if (r < I_A) { const int nb = D / 32, kb = r / nb, n0 = 32 * (r % nb); p0_transpose_item(I.w_conv_out, D, Wac_t, D, 64 * kb, n0, n0, 512, scr, F.lane); continue; } r -= I_A;
        if (r < I_O) { const int nb = D / 32, kb = r / nb, n0 = 32 * (r % nb); p0_transpose_item(I.w_out, D, Wout_t, D, 64 * kb, n0, n0, 0, scr, F.lane); continue; } r -= I_O;
        if (r < I_G) { const int nb = D_FF / 32, kb = r / nb, n0 = 32 * (r % nb); p0_transpose_item(I.w_gate, D_FF, Wgu_t, D, 64 * kb, n0, (n0 >> 7) * 256 + (n0 & 127), 0, scr, F.lane); continue; } r -= I_G;
        if (r < I_G) { const int nb = D_FF / 32, kb = r / nb, n0 = 32 * (r % nb); p0_transpose_item(I.w_up, D_FF, Wgu_t, D, 64 * kb, n0, (n0 >> 7) * 256 + 128 + (n0 & 127), 0, scr, F.lane); continue; } r -= I_G;
        { const int nb = D / 32, kb = r / nb, n0 = 32 * (r % nb); p0_transpose_item(I.w_down, D, Wd_t, D_FF, 64 * kb, n0, n0, 0, scr, F.lane); }
    }
    float* stats = (float*)(ws + WS_STATS); bf16* XN = (bf16*)(ws + WS_XN);
    for (int m = gw; m < M; m += NGW) ln_in_row(I.x + (size_t)m * D, I.ln_in_g, I.ln_in_b, XN + (size_t)m * D, stats + 2 * (size_t)m, F.lane);
    float* biasin = (float*)(ws + WS_BIASIN);
    for (int i = blockIdx.x * (NWAVES * 64) + F.tid; i < IN_COLS; i += F.G * NWAVES * 64) biasin[i] = (i >= mk::O_GA) ? I.b_gate[i - mk::O_GA] : 0.f;
}

namespace attn {
typedef short bf16x8 __attribute__((ext_vector_type(8)));
typedef short s16x4 __attribute__((ext_vector_type(4)));
typedef float f32x16 __attribute__((ext_vector_type(16)));
typedef unsigned u32x4 __attribute__((ext_vector_type(4)));
typedef float f32x2_t __attribute__((ext_vector_type(2))); typedef __bf16 bf16x2_t __attribute__((ext_vector_type(2)));
constexpr int KL_OFF = 0, VL_OFF = 49152, BT_OFF = 98304, WSF_OFF = BT_OFF + 8192, ATT_END = WSF_OFF + 2048;
static_assert(ATT_END <= RING_BYTES, "attention LDS");
__device__ __forceinline__ int crow(int r, int hi) { return (r & 3) + 8 * (r >> 2) + 4 * hi; }
__device__ __forceinline__ unsigned cvtpk_s(float lo, float hi) { f32x2_t v = {lo, hi}; bf16x2_t b = __builtin_convertvector(v, bf16x2_t); return __builtin_bit_cast(unsigned, b); }
__device__ __forceinline__ s16x4 vtr(LAS const unsigned char* p) { return __builtin_bit_cast(s16x4, __builtin_amdgcn_ds_read_tr16_b64_v4i16((LAS s16x4*)p)); }
__device__ __forceinline__ int t5_bucket(int rel) {
    const int n = rel < 0 ? -rel : rel;
    int v;
    if (n < 8) v = n;
    else v = 8 + (n >= 12) + (n >= 16) + (n >= 23) + (n >= 32) + (n >= 46) + (n >= 64) + (n >= 91);
    return v + (rel > 0 ? 16 : 0);
}
__device__ __forceinline__ void attn_unit(LAS unsigned char* lds, const bf16* U, bf16* OC, const float* rel_bias, const float* sink, int unit, int tid, int wave, int lane) {
    const int g = unit & 1, blk = (unit >> 1) & 15, b = unit >> 5;
    const int rb = b * SEQ + blk * 128;
    const int kj_lo = (blk == 0) ? 128 : 0, kj_hi = (blk == 15) ? 256 : 384;
    for (int idx = tid; idx < 3072; idx += 512) { const int c = idx / 384, key = idx - c * 384;
        if (key >= kj_lo && key < kj_hi) { const u32x4 v = *(const GAS u32x4*)(U + (size_t)(rb - 128 + key) * IN_COLS + mk::O_K + g * 64 + c * 8);
            *(LAS u32x4*)(lds + KL_OFF + (key >> 6) * 8192 + c * 1024 + (key & 63) * 16) = v; } }
    for (int idx = tid; idx < 3072; idx += 512) { const int q4 = idx & 3, kk = idx >> 2, ch = kk / 384, key = kk - ch * 384;
        if (key >= kj_lo && key < kj_hi) { const u32x4 v = *(const GAS u32x4*)(U + (size_t)(rb - 128 + key) * IN_COLS + mk::O_V + g * 64 + ch * 32 + q4 * 8);
            *(LAS u32x4*)(lds + VL_OFF + (key >> 6) * 8192 + ch * 4096 + ((key & 63) >> 4) * 1024 + (key & 15) * 64 + q4 * 16) = v; } }
    { LAS float* BT = (LAS float*)(lds + BT_OFF);
      for (int i = tid; i < 2048; i += 512) { const int hl = i >> 9, idx = i & 511, rel = idx - 255;
          BT[i] = (rel >= -128 && rel <= 128) ? rel_bias[t5_bucket(rel) * 8 + g * 4 + hl] * mk::LOG2E : -1e30f; } }
    __syncthreads();
    const int r32 = lane & 31, hi = lane >> 5, hl = wave >> 1, hq = g * 4 + hl;
    LAS float* wsf = (LAS float*)(lds + WSF_OFF) + wave * 64;
    const LAS float* BTh = (const LAS float*)(lds + BT_OFF) + hl * 512;
    const float sinkl2 = sink[hq] * mk::LOG2E;
    const LAS unsigned char* vbase = lds + VL_OFF + ((lane >> 4) & 1) * 32 + (lane & 3) * 8 + (4 * hi + ((lane & 15) >> 2)) * 64;
    const LAS unsigned char* kbase = lds + KL_OFF + hi * 1024 + r32 * 16;
#pragma unroll 1
    for (int sbi = 0; sbi < 2; ++sbi) {
        const int sb = 2 * (wave & 1) + sbi, q0 = 32 * sb, qi = q0 + r32;
        bf16x8 qr[4];
#pragma unroll
        for (int d0 = 0; d0 < 4; ++d0) qr[d0] = *(const GAS bf16x8*)(U + (size_t)(rb + qi) * IN_COLS + hq * 64 + d0 * 16 + hi * 8);
        float m_run = sinkl2, l_run = (hi == 0) ? 1.f : 0.f;
        f32x16 o0 = {}, o1 = {};
        const int jlo = sb >> 1;
#pragma unroll 1
        for (int j = jlo; j < jlo + 5; ++j) {
            const int kb = j >> 1;
            if ((blk == 0 && kb == 0) || (blk == 15 && kb == 2)) continue;
            f32x16 p0 = {}, p1 = {};
#pragma unroll
            for (int d0 = 0; d0 < 4; ++d0) {
                const bf16x8 k0 = *(const LAS bf16x8*)(kbase + j * 8192 + d0 * 2048), k1 = *(const LAS bf16x8*)(kbase + j * 8192 + d0 * 2048 + 512);
                p0 = __builtin_amdgcn_mfma_f32_32x32x16_bf16(k0, qr[d0], p0, 0, 0, 0);
                p1 = __builtin_amdgcn_mfma_f32_32x32x16_bf16(k1, qr[d0], p1, 0, 0, 0);
            }
            const LAS float* tb = BTh + (j * 64 + 4 * hi - qi + 127);
            float mx = -3.0e38f;
#pragma unroll
            for (int r = 0; r < 16; ++r) { const int ko = (r & 3) + 8 * (r >> 2); p0[r] += tb[ko]; p1[r] += tb[32 + ko]; mx = __builtin_fmaxf(mx, __builtin_fmaxf(p0[r], p1[r])); }
            mx = __builtin_fmaxf(mx, __shfl_xor(mx, 32));
            const float mnew = __builtin_fmaxf(m_run, mx), alpha = __builtin_amdgcn_exp2f(m_run - mnew);
            m_run = mnew;
            float rs = 0.f;
#pragma unroll
            for (int r = 0; r < 16; ++r) { p0[r] = __builtin_amdgcn_exp2f(p0[r] - mnew); p1[r] = __builtin_amdgcn_exp2f(p1[r] - mnew); rs += p0[r] + p1[r]; }
            l_run = l_run * alpha + rs;
            if (!__all(alpha == 1.0f)) {
                if (hi == 0) wsf[r32] = alpha;
                asm volatile("s_waitcnt lgkmcnt(0)" ::: "memory");
#pragma unroll
                for (int r = 0; r < 16; ++r) { const float f = wsf[crow(r, hi)]; o0[r] *= f; o1[r] *= f; }
                asm volatile("s_waitcnt lgkmcnt(0)" ::: "memory");
            }
            u32x4 pw0, pw1, pw2, pw3;
            pw0 = (u32x4){cvtpk_s(p0[0], p0[1]), cvtpk_s(p0[2], p0[3]), cvtpk_s(p0[4], p0[5]), cvtpk_s(p0[6], p0[7])};
            pw1 = (u32x4){cvtpk_s(p0[8], p0[9]), cvtpk_s(p0[10], p0[11]), cvtpk_s(p0[12], p0[13]), cvtpk_s(p0[14], p0[15])};
            pw2 = (u32x4){cvtpk_s(p1[0], p1[1]), cvtpk_s(p1[2], p1[3]), cvtpk_s(p1[4], p1[5]), cvtpk_s(p1[6], p1[7])};
            pw3 = (u32x4){cvtpk_s(p1[8], p1[9]), cvtpk_s(p1[10], p1[11]), cvtpk_s(p1[12], p1[13]), cvtpk_s(p1[14], p1[15])};
            const LAS unsigned char* vp = vbase + j * 8192;
#define ATT_PV(OACC, d0, ks, PW) do { const s16x4 lo_ = vtr(vp + (d0) * 4096 + (ks) * 1024), hi_ = vtr(vp + (d0) * 4096 + (ks) * 1024 + 512); \
        const bf16x8 vf_ = (bf16x8){lo_[0], lo_[1], lo_[2], lo_[3], hi_[0], hi_[1], hi_[2], hi_[3]}; \
        OACC = __builtin_amdgcn_mfma_f32_32x32x16_bf16(__builtin_bit_cast(bf16x8, PW), vf_, OACC, 0, 0, 0); } while (0)
            ATT_PV(o0, 0, 0, pw0); ATT_PV(o1, 1, 0, pw0); ATT_PV(o0, 0, 1, pw1); ATT_PV(o1, 1, 1, pw1);
            ATT_PV(o0, 0, 2, pw2); ATT_PV(o1, 1, 2, pw2); ATT_PV(o0, 0, 3, pw3); ATT_PV(o1, 1, 3, pw3);
#undef ATT_PV
        }
        const float lt = l_run + __shfl_xor(l_run, 32);
        if (hi == 0) wsf[32 + r32] = lt;
        asm volatile("s_waitcnt lgkmcnt(0)" ::: "memory");
        bf16* orow = OC + (size_t)(rb + q0) * D + hq * 64 + r32;
#pragma unroll
        for (int r = 0; r < 16; ++r) { const int q = crow(r, hi); const float inv = 1.0f / wsf[32 + q];
            orow[(size_t)q * D] = (bf16)f2bf(o0[r] * inv); orow[(size_t)q * D + 32] = (bf16)f2bf(o1[r] * inv); }
        asm volatile("s_waitcnt lgkmcnt(0)" ::: "memory");
    }
}
}

__device__ __forceinline__ void conv_unit(LAS unsigned char* lds, const bf16* U, bf16* OC, const float* cw, const float* cb, const float* lg, const float* lb, int t0, int tid, int wave, int lane) {
    const int c = tid, s0 = t0 & (SEQ - 1), rbase = t0 - s0;
    float w[31];
#pragma unroll
    for (int i = 0; i < 31; ++i) w[i] = cw[i * 512 + c];
    const float bias = cb[c];
    LAS float* dw = (LAS float*)lds;
    const f32x4 g0 = ((const GAS f32x4*)lg)[lane], g1 = ((const GAS f32x4*)lg)[64 + lane], b0 = ((const GAS f32x4*)lb)[lane], b1 = ((const GAS f32x4*)lb)[64 + lane];
#pragma unroll 1
    for (int grp = 0; grp < 4; ++grp) {
        const int tg = s0 + 16 * grp;
        float acc[16];
#pragma unroll
        for (int o = 0; o < 16; ++o) acc[o] = bias;
#pragma unroll
        for (int i = 0; i < 46; ++i) {
            const int r = tg - 15 + i; float gv = 0.f;
            if (r >= 0 && r < SEQ) { const bf16* up = U + (size_t)(rbase + r) * IN_COLS + c; const float a = __uint_as_float((unsigned)up[mk::O_CA] << 16), bb = __uint_as_float((unsigned)up[mk::O_CB] << 16); gv = a * mk::sigm(bb); }
#pragma unroll
            for (int o = 0; o < 16; ++o) if (i - o >= 0 && i - o <= 30) acc[o] += gv * w[i - o];
        }
#pragma unroll
        for (int o = 0; o < 16; ++o) dw[o * 512 + c] = acc[o];
        __syncthreads();
#pragma unroll
        for (int k = 0; k < 2; ++k) { const int o = wave * 2 + k;
            f32x4 v0 = *(const LAS f32x4*)(dw + o * 512 + lane * 4), v1 = *(const LAS f32x4*)(dw + o * 512 + 256 + lane * 4);
            const float mean = wave_sum((v0.x + v0.y) + (v0.z + v0.w) + (v1.x + v1.y) + (v1.z + v1.w)) * (1.f / 512.f);
            v0 = v0 - mean; v1 = v1 - mean;
            const float var = wave_sum((v0.x * v0.x + v0.y * v0.y) + (v0.z * v0.z + v0.w * v0.w) + (v1.x * v1.x + v1.y * v1.y) + (v1.z * v1.z + v1.w * v1.w)) * (1.f / 512.f);
            const float rstd = 1.f / sqrtf(var + LN_EPS);
            f32x4 y0 = v0 * rstd * g0 + b0, y1 = v1 * rstd * g1 + b1;
#pragma unroll
            for (int e = 0; e < 4; ++e) { y0[e] = y0[e] * mk::sigm(y0[e]); y1[e] = y1[e] * mk::sigm(y1[e]); }
            bf16* op = OC + (size_t)(t0 + 16 * grp + o) * D + 512 + lane * 4;
            *(GAS unsigned long long*)op = (unsigned long long)pk2(y0.x, y0.y) | ((unsigned long long)pk2(y0.z, y0.w) << 32);
            *(GAS unsigned long long*)(op + 256) = (unsigned long long)pk2(y1.x, y1.y) | ((unsigned long long)pk2(y1.z, y1.w) << 32); }
        __syncthreads();
    }
}

__global__ void __launch_bounds__(NWAVES * 64, 2) mega_fwd(Args args) {
    extern __shared__ __attribute__((aligned(16))) unsigned char lds[];
    Frame F;
    F.lds = (LAS unsigned char*)lds;
    F.MISC = (volatile LAS unsigned*)(F.lds + MISC_OFF);
    F.tid = threadIdx.x; F.lane = F.tid & 63; F.wave = __builtin_amdgcn_readfirstlane(F.tid >> 6);
    F.G = gridDim.x; { const int bx = blockIdx.x; F.vcu = (F.G % 8 == 0) ? (bx % 8) * (F.G / 8) + bx / 8 : bx; }
    unsigned char* ws = args.ws;
    F.ctl = (gu32*)(ws + WS_CTL);
    In I;
    I.x = args.in[0]; I.ln_in_g = args.in[1]; I.ln_in_b = args.in[2]; I.rel_bias = args.in[3]; I.w_in = args.in[4]; I.b_gate = args.in[5]; I.conv_w = args.in[6]; I.conv_b = args.in[7];
    I.conv_ln_g = args.in[8]; I.conv_ln_b = args.in[9]; I.w_conv_out = args.in[10]; I.w_attn_out = args.in[11]; I.sink = args.in[12]; I.w_out = args.in[13]; I.ln1_g = args.in[14]; I.ln1_b = args.in[15];
    I.w_gate = args.in[16]; I.w_up = args.in[17]; I.w_down = args.in[18]; I.ln2_g = args.in[19]; I.ln2_b = args.in[20];
    float* out = args.out;
    bf16* Win_t = (bf16*)(ws + WS_WIN); bf16* Wac_t = (bf16*)(ws + WS_WAC); bf16* Wout_t = (bf16*)(ws + WS_WOUT); bf16* Wgu_t = (bf16*)(ws + WS_WGU); bf16* Wd_t = (bf16*)(ws + WS_WD);
    bf16* XN = (bf16*)(ws + WS_XN); bf16* MERGED = (bf16*)(ws + WS_MERGED); bf16* U = (bf16*)(ws + WS_U); bf16* HID = (bf16*)(ws + WS_HID); bf16* OC = (bf16*)(ws + WS_OC); bf16* HN = (bf16*)(ws + WS_HN);
    const float* stats = (const float*)(ws + WS_STATS); const float* biasin = (const float*)(ws + WS_BIASIN);

    for (int u = F.tid; u < (LDS_BYTES - LDSCTL_OFF) / 4; u += NWAVES * 64) ((LAS unsigned*)(F.lds + LDSCTL_OFF))[u] = 0u;
    __syncthreads();
    XcdBarrier bar; bar.bar = (unsigned*)(F.ctl + CW_BAR); bar.x = 0; bar.st = nullptr;
    if (N_LAUNCHES == 1) bar = xcd_barrier_post((unsigned*)(F.ctl + CW_BAR), F.MISC + 8);
#define GRID_BAR() do { if (N_LAUNCHES == 1) xcd_barrier(bar); } while (0)
    const int lo = args.ph_lo, hi = args.ph_hi;
#ifndef MK_PH_MASK
#define MK_PH_MASK 0x1ff
#endif
#define IN(k) (((MK_PH_MASK >> (k)) & 1) && lo <= (k) && (k) < hi)
#define BOTH(k) (IN(k) && IN((k) + 1))

    if (IN(0)) { p0_prologue(F, I, ws); if (BOTH(0)) GRID_BAR(); }

    if (IN(1)) {
        pg8::Gemm g{XN, Win_t, M, IN_COLS, D}; pg8::StaticOrder S; S.init(M, IN_COLS, F.G, (int)blockIdx.x);
        pg8::EpiBf16<0> E{U, IN_COLS, biasin, 512, 512, C2};
        pg8::gemm_phase<pg8::EpiBf16<0>, pg8::StaticOrder, true, true>(F.lds + RING_OFF, g, S, E);
        if (BOTH(1)) GRID_BAR();
    }

    if (IN(2)) {
        for (int unit = F.vcu; unit < 256; unit += F.G) { attn::attn_unit(F.lds + RING_OFF, U, OC, I.rel_bias, I.sink, unit, F.tid, F.wave, F.lane); __syncthreads(); }
        for (int cu = F.vcu; cu < M / 64; cu += F.G) conv_unit(F.lds + RING_OFF, U, OC, I.conv_w, I.conv_b, I.conv_ln_g, I.conv_ln_b, cu * 64, F.tid, F.wave, F.lane);
        if (BOTH(2)) GRID_BAR();
    }

    if (IN(3)) {
        pg8::Gemm g{OC, Wac_t, M, D, D}; pg8::StaticOrder S; S.init(M, D, F.G, (int)blockIdx.x);
        mk::EpiMerge E{U, MERGED};
        pg8::gemm_phase<mk::EpiMerge, pg8::StaticOrder, true, true>(F.lds + RING_OFF, g, S, E);
        if (BOTH(3)) GRID_BAR();
    }

    if (IN(4)) {
        pg8::Gemm g{MERGED, Wout_t, M, D, D}; pg8::StaticOrder S; S.init(M, D, F.G, (int)blockIdx.x);
        mk::EpiResid<0> E{I.x, stats, I.ln_in_g, I.ln_in_b, out};
        pg8::gemm_phase<mk::EpiResid<0>, pg8::StaticOrder, true, true>(F.lds + RING_OFF, g, S, E);
        if (BOTH(4)) GRID_BAR();
    }

    if (IN(5)) { ln_rows_pass(F, out, I.ln1_g, I.ln1_b, HN); if (BOTH(5)) GRID_BAR(); }

    if (IN(6)) {
        pg8::Gemm g{HN, Wgu_t, M, NGU, D}; pg8::StaticOrder S; S.init(M, NGU, F.G, (int)blockIdx.x);
        mk::EpiSwiGLU E{HID};
        pg8::gemm_phase<mk::EpiSwiGLU, pg8::StaticOrder, true, true>(F.lds + RING_OFF, g, S, E);
        if (BOTH(6)) GRID_BAR();
    }

    if (IN(7)) {
        pg8::Gemm g{HID, Wd_t, M, D, D_FF}; pg8::StaticOrder S; S.init(M, D, F.G, (int)blockIdx.x);
        mk::EpiResid<1> E{nullptr, nullptr, nullptr, nullptr, out};
        pg8::gemm_phase<mk::EpiResid<1>, pg8::StaticOrder, true, true>(F.lds + RING_OFF, g, S, E);
        if (BOTH(7)) GRID_BAR();
    }

    if (IN(8)) { ln_rows_pass(F, out, I.ln2_g, I.ln2_b, nullptr); }
#undef IN
#undef BOTH
#undef GRID_BAR
}

extern "C" void kernel_launch(void* const* d_in, const int* in_sizes, int n_in, void* d_out, int out_size, void* d_ws, size_t ws_size, hipStream_t stream) {
    static int grid = 0;
    if (grid == 0) {
        if (n_in != 21 || in_sizes[0] != M * D || out_size != M * D || ws_size < WS_END) { fprintf(stderr, "kernel_launch: unexpected shapes (n_in %d, in0 %d, out %d, ws %zu); nothing launched\n", n_in, n_in > 0 ? in_sizes[0] : -1, out_size, ws_size); grid = -1; return; }
        int dev = 0, cus = 0, per_cu = 0;
        if (hipGetDevice(&dev) != hipSuccess || hipDeviceGetAttribute(&cus, hipDeviceAttributeMultiprocessorCount, dev) != hipSuccess) { fprintf(stderr, "kernel_launch: device query failed\n"); grid = -1; return; }
        if (hipFuncSetAttribute((const void*)mega_fwd, hipFuncAttributeMaxDynamicSharedMemorySize, LDS_BYTES) != hipSuccess) { fprintf(stderr, "kernel_launch: hipFuncSetAttribute failed\n"); grid = -1; return; }
        if (hipOccupancyMaxActiveBlocksPerMultiprocessor(&per_cu, (const void*)mega_fwd, NWAVES * 64, LDS_BYTES) != hipSuccess || per_cu < 1)
            fprintf(stderr, "kernel_launch: note: occupancy query reports %d workgroups per CU\n", per_cu);
        (void)hipGetLastError();
        grid = cus;
    }
    if (grid < 0) return;
    if (hipMemsetAsync((char*)d_ws + WS_CTL, 0, CTL_ZERO_BYTES, stream) != hipSuccess) { fprintf(stderr, "kernel_launch: hipMemsetAsync failed\n"); return; }
    Args a{};
    for (int i = 0; i < 21; ++i) a.in[i] = (const float*)d_in[i];
    a.out = (float*)d_out; a.ws = (unsigned char*)d_ws;
    for (int li = 0; li < N_LAUNCHES; ++li) {
        a.ph_lo = (N_LAUNCHES == 1) ? 0 : li; a.ph_hi = (N_LAUNCHES == 1) ? N_PHASES : li + 1;
        hipLaunchKernelGGL(mega_fwd, dim3(grid), dim3(NWAVES * 64), LDS_BYTES, stream, a);
        const hipError_t le = hipPeekAtLastError();
        if (le != hipSuccess) { fprintf(stderr, "kernel_launch: launch %d failed: %s\n", li, hipGetErrorName(le)); break; }
    }
}
```
